# Optimizing an MI355X kernel written in HIP

```python
import math
import jax, jax.numpy as jnp
from jax import lax
import numpy as np

D_MODEL = 2048
BATCH = 1
SEQ = 8192
DEPTH = 1

D_MIX = D_MODEL
HEAD_DIM = 64
D_ATTN = D_MIX // 2
D_CONV = D_MIX - D_ATTN
N_Q_HEADS = D_ATTN // HEAD_DIM
N_KV_HEADS = 4
GQA_GROUP = N_Q_HEADS // N_KV_HEADS
D_KV = N_KV_HEADS * HEAD_DIM
WINDOW = 128
BLOCK = 128
CONV_WIDTH = 31
CONV_GROUPS = D_CONV // HEAD_DIM
N_BUCKETS = 32
MAX_DISTANCE = 128
LN_EPS = 1e-5
ALPHA = (2.0 * DEPTH) ** 0.25
BETA = (8.0 * DEPTH) ** -0.25

SPLIT_SIZES = (D_ATTN, D_KV, D_KV, D_ATTN, D_CONV, D_CONV, D_CONV)
D_IN = sum(SPLIT_SIZES)
SPLIT_POINTS = [int(s) for s in np.cumsum(SPLIT_SIZES)[:-1]]

kernel_name = "hybrid_conformer_swa_sink_deepnorm_adaln"


def layer_norm(x, g, b):
    xf = x.astype(jnp.float32)
    mu = jnp.mean(xf, axis=-1, keepdims=True)
    var = jnp.mean(jnp.square(xf - mu), axis=-1, keepdims=True)
    y = (xf - mu) * lax.rsqrt(var + LN_EPS)
    return (y * g.astype(jnp.float32) + b.astype(jnp.float32)).astype(x.dtype)


def t5_bucket(dist):
    max_exact = N_BUCKETS // 2
    d = jnp.maximum(dist, 1).astype(jnp.float32)
    large = max_exact + (jnp.log(d / max_exact) / math.log(MAX_DISTANCE / max_exact)
                         * (N_BUCKETS - max_exact)).astype(jnp.int32)
    large = jnp.minimum(large, N_BUCKETS - 1)
    return jnp.where(dist < max_exact, dist, large)


def banded_sink_attention(q, k, v, rel_bias, sinks):
    B, S = q.shape[0], q.shape[1]
    nb = S // BLOCK
    f32 = jnp.float32
    qb = q.astype(f32).reshape(B, nb, BLOCK, N_KV_HEADS, GQA_GROUP, HEAD_DIM)
    kb = k.astype(f32).reshape(B, nb, BLOCK, N_KV_HEADS, HEAD_DIM)
    vb = v.astype(f32).reshape(B, nb, BLOCK, N_KV_HEADS, HEAD_DIM)
    prev = lambda t: jnp.concatenate([jnp.zeros_like(t[:, :1]), t[:, :-1]], axis=1)
    kw = jnp.concatenate([prev(kb), kb], axis=2)
    vw = jnp.concatenate([prev(vb), vb], axis=2)
    scores = jnp.einsum('bnqhgd,bnkhd->bnhgqk', qb, kw) * (HEAD_DIM ** -0.5)

    qi = jnp.arange(BLOCK, dtype=jnp.int32)[:, None]
    kj = jnp.arange(2 * BLOCK, dtype=jnp.int32)[None, :]
    dist = qi + BLOCK - kj
    in_window = (dist >= 0) & (dist < WINDOW)
    bias = rel_bias.astype(f32)[t5_bucket(jnp.maximum(dist, 0))]
    bias = bias.transpose(2, 0, 1).reshape(N_KV_HEADS, GQA_GROUP, BLOCK, 2 * BLOCK)
    key_pos = jnp.arange(nb, dtype=jnp.int32)[:, None] * BLOCK - BLOCK + kj
    valid = in_window[None] & (key_pos[:, None, :] >= 0)

    scores = jnp.where(valid[None, :, None, None], scores + bias, jnp.finfo(f32).min)
    sink = jnp.broadcast_to(sinks.astype(f32).reshape(1, 1, N_KV_HEADS, GQA_GROUP, 1, 1),
                            scores.shape[:-1] + (1,))
    probs = jax.nn.softmax(jnp.concatenate([scores, sink], axis=-1), axis=-1)[..., :-1]
    out = jnp.einsum('bnhgqk,bnkhd->bnqhgd', probs, vw)
    return out.reshape(B, S, N_Q_HEADS * HEAD_DIM).astype(q.dtype)


def conformer_conv(glu_a, glu_b, conv_w, conv_b, ln_g, ln_b, w_pw, b_pw):
    u = glu_a * jax.nn.sigmoid(glu_b)
    u = lax.conv_general_dilated(
        u, conv_w.reshape(CONV_WIDTH, 1, D_CONV).astype(u.dtype),
        window_strides=(1,), padding=[(CONV_WIDTH - 1, 0)],
        dimension_numbers=('NWC', 'WIO', 'NWC'), feature_group_count=D_CONV) + conv_b
    u = jax.nn.silu(layer_norm(u, ln_g, ln_b))
    return u @ w_pw + b_pw


def setup_inputs(seed: int = 0) -> dict:
    key = jax.random.key(seed)
    ks = jax.random.split(key, 20)
    n = jax.random.normal
    f32 = jnp.float32
    x = n(ks[0], (BATCH, SEQ, D_MODEL), f32)
    c = n(ks[1], (BATCH, D_MODEL), f32)
    w_ada = 0.5 * D_MODEL ** -0.5 * n(ks[2], (DEPTH, D_MODEL, 3 * D_MODEL), f32)
    b_ada = 0.01 * n(ks[3], (DEPTH, 3 * D_MODEL), f32)
    col_scale = jnp.ones((D_IN,), f32).at[D_ATTN + D_KV:D_ATTN + 2 * D_KV].set(BETA)
    w_in = D_MODEL ** -0.5 * n(ks[4], (DEPTH, D_MODEL, D_IN), f32) * col_scale
    rel_bias = 0.5 * n(ks[5], (N_BUCKETS, N_Q_HEADS), f32)
    sinks = n(ks[6], (DEPTH, N_Q_HEADS), f32)
    conv_w = CONV_WIDTH ** -0.5 * n(ks[7], (DEPTH, CONV_WIDTH, D_CONV), f32)
    conv_b = 0.01 * n(ks[8], (DEPTH, D_CONV), f32)
    conv_ln_g = 1.0 + 0.01 * n(ks[9], (DEPTH, D_CONV), f32)
    conv_ln_b = 0.01 * n(ks[10], (DEPTH, D_CONV), f32)
    w_pw = BETA * D_CONV ** -0.5 * n(ks[11], (DEPTH, D_CONV, D_CONV), f32)
    b_pw = 0.01 * n(ks[12], (DEPTH, D_CONV), f32)
    w_out = BETA * D_MIX ** -0.5 * n(ks[13], (DEPTH, D_MIX, D_MODEL), f32)
    ln_g = 1.0 + 0.01 * n(ks[14], (DEPTH, D_MODEL), f32)
    ln_b = 0.01 * n(ks[15], (DEPTH, D_MODEL), f32)
    return {"x": x, "c": c, "w_ada": w_ada, "b_ada": b_ada, "w_in": w_in,
            "rel_bias": rel_bias, "sinks": sinks, "conv_w": conv_w, "conv_b": conv_b,
            "conv_ln_g": conv_ln_g, "conv_ln_b": conv_ln_b, "w_pw": w_pw, "b_pw": b_pw,
            "w_out": w_out, "ln_g": ln_g, "ln_b": ln_b}


def reference(x, c, w_ada, b_ada, w_in, rel_bias, sinks, conv_w, conv_b, conv_ln_g,
              conv_ln_b, w_pw, b_pw, w_out, ln_g, ln_b):
    c_act = jax.nn.silu(c)
    for l in range(DEPTH):
        mod = (c_act @ w_ada[l] + b_ada[l])[:, None, :]
        shift, scale, gate = jnp.split(mod, 3, axis=-1)
        h = x * (1.0 + scale) + shift
        proj = h @ w_in[l]
        q, k, v, g_attn, glu_a, glu_b, g_conv = jnp.split(proj, SPLIT_POINTS, axis=-1)
        y_attn = banded_sink_attention(q, k, v, rel_bias, sinks[l]) * jax.nn.silu(g_attn)
        y_conv = conformer_conv(glu_a, glu_b, conv_w[l], conv_b[l], conv_ln_g[l], conv_ln_b[l],
                                w_pw[l], b_pw[l]) * jax.nn.silu(g_conv)
        y = jnp.concatenate([y_attn, y_conv], axis=-1) @ w_out[l]
        x = layer_norm(ALPHA * x + gate * y, ln_g[l], ln_b[l])
    return x
```

```cpp
#include <hip/hip_runtime.h>
#include <cstdint>
#include <cstdio>

constexpr int SEQ = 8192, DM = 2048, DIN = 5632, DA = 1024, DKV = 256, DC = 1024;
constexpr int OFF_Q = 0, OFF_K = 1024, OFF_V = 1280, OFF_GA = 1536, OFF_A = 2560, OFF_B = 3584, OFF_GC = 4608;
constexpr float LN_EPS = 1e-5f;
constexpr float ALPHA = 1.189207115002721f;

__device__ __forceinline__ float sigmoidf_(float v) { return 1.f / (1.f + __expf(-v)); }
__device__ __forceinline__ float siluf_(float v) { return v * sigmoidf_(v); }

__global__ void __launch_bounds__(512) k_mod(const float* __restrict__ c, const float* __restrict__ w_ada, const float* __restrict__ b_ada, float* __restrict__ mod) {
    __shared__ float red[8][64];
    const int tx = threadIdx.x & 63, ty = threadIdx.x >> 6;
    const int n = blockIdx.x * 64 + tx;
    float acc = 0.f;
    for (int k = ty * 256; k < ty * 256 + 256; ++k) acc += siluf_(c[k]) * w_ada[(size_t)k * 6144 + n];
    red[ty][tx] = acc;
    __syncthreads();
    if (ty == 0) { float s = 0.f; for (int i = 0; i < 8; ++i) s += red[i][tx]; mod[n] = s + b_ada[n]; }
}

template <int MODE>
__global__ void __launch_bounds__(256) k_sgemm(const float* __restrict__ A, int lda, const float* __restrict__ B, int ldb, float* __restrict__ C, int ldc, int K,
                                               const float* __restrict__ p0, const float* __restrict__ p1) {
    __shared__ float As[16][68];
    __shared__ float Bs[16][68];
    const int tid = threadIdx.x, tx = tid & 15, ty = tid >> 4;
    const int m0 = blockIdx.y * 64, n0 = blockIdx.x * 64;
    float acc[4][4];
#pragma unroll
    for (int i = 0; i < 4; ++i)
#pragma unroll
        for (int j = 0; j < 4; ++j) acc[i][j] = 0.f;
    const int ar = tid >> 2, ak = (tid & 3) * 4;
    const int bk = tid >> 4, bn = (tid & 15) * 4;
    for (int k0 = 0; k0 < K; k0 += 16) {
        float4 av = *(const float4*)(A + (size_t)(m0 + ar) * lda + k0 + ak);
        if (MODE == 0) {
            const float* scale = p0; const float* shift = p1;
            av.x = av.x * (1.f + scale[k0 + ak + 0]) + shift[k0 + ak + 0];
            av.y = av.y * (1.f + scale[k0 + ak + 1]) + shift[k0 + ak + 1];
            av.z = av.z * (1.f + scale[k0 + ak + 2]) + shift[k0 + ak + 2];
            av.w = av.w * (1.f + scale[k0 + ak + 3]) + shift[k0 + ak + 3];
        }
        const float4 bv = *(const float4*)(B + (size_t)(k0 + bk) * ldb + n0 + bn);
        __syncthreads();
        As[ak + 0][ar] = av.x; As[ak + 1][ar] = av.y; As[ak + 2][ar] = av.z; As[ak + 3][ar] = av.w;
        *(float4*)&Bs[bk][bn] = bv;
        __syncthreads();
#pragma unroll
        for (int kk = 0; kk < 16; ++kk) {
            const float4 a4 = *(const float4*)&As[kk][ty * 4];
            const float4 b4 = *(const float4*)&Bs[kk][tx * 4];
            const float a[4] = {a4.x, a4.y, a4.z, a4.w}, b[4] = {b4.x, b4.y, b4.z, b4.w};
#pragma unroll
            for (int i = 0; i < 4; ++i)
#pragma unroll
                for (int j = 0; j < 4; ++j) acc[i][j] += a[i] * b[j];
        }
    }
#pragma unroll
    for (int i = 0; i < 4; ++i) {
        const int m = m0 + ty * 4 + i;
#pragma unroll
        for (int j = 0; j < 4; ++j) {
            const int n = n0 + tx * 4 + j;
            float v = acc[i][j];
            if (MODE == 1) { const float g = p1[(size_t)m * DIN + n]; v = (v + p0[n]) * siluf_(g); C[(size_t)m * ldc + 1024 + n] = v; }
            else if (MODE == 2) { v = ALPHA * p0[(size_t)m * DM + n] + p1[n] * v; C[(size_t)m * ldc + n] = v; }
            else C[(size_t)m * ldc + n] = v;
        }
    }
}

__device__ __forceinline__ int t5_bucket(int dist) {
    if (dist < 16) return dist;
    int l = 16 + (int)(logf((float)dist / 16.f) / logf(8.f) * 16.f);
    return l < 31 ? l : 31;
}

__global__ void __launch_bounds__(256) k_attn(const float* __restrict__ proj, const float* __restrict__ rel_bias, const float* __restrict__ sinks, float* __restrict__ ycat) {
    const int w = (blockIdx.x * 256 + threadIdx.x) >> 6, d = threadIdx.x & 63;
    const int t = w >> 4, h = w & 15, kvh = h >> 2;
    const float q = proj[(size_t)t * DIN + OFF_Q + h * 64 + d];
    float m = -INFINITY, l = 0.f, acc = 0.f;
    const int j0 = t - 127 < 0 ? 0 : t - 127;
    for (int j = j0; j <= t; ++j) {
        const float kk = proj[(size_t)j * DIN + OFF_K + kvh * 64 + d];
        const float vv = proj[(size_t)j * DIN + OFF_V + kvh * 64 + d];
        float s = q * kk;
#pragma unroll
        for (int o = 1; o < 64; o <<= 1) s += __shfl_xor(s, o);
        s = s * 0.125f + rel_bias[t5_bucket(t - j) * 16 + h];
        const float mn = fmaxf(m, s);
        const float al = __expf(m - mn), p = __expf(s - mn);
        l = l * al + p; acc = acc * al + p * vv; m = mn;
    }
    const float sk = sinks[h];
    const float mf = fmaxf(m, sk);
    const float al = __expf(m - mf);
    l = l * al + __expf(sk - mf); acc = acc * al;
    const float o = acc / l;
    const float g = proj[(size_t)t * DIN + OFF_GA + h * 64 + d];
    ycat[(size_t)t * DM + h * 64 + d] = o * siluf_(g);
}

__device__ __forceinline__ float block_sum_256(float v, float* red) {
#pragma unroll
    for (int o = 1; o < 64; o <<= 1) v += __shfl_xor(v, o);
    __syncthreads();
    if ((threadIdx.x & 63) == 0) red[threadIdx.x >> 6] = v;
    __syncthreads();
    return red[0] + red[1] + red[2] + red[3];
}

__global__ void __launch_bounds__(256) k_conv(const float* __restrict__ proj, const float* __restrict__ conv_w, const float* __restrict__ conv_b,
                                              const float* __restrict__ g, const float* __restrict__ b, float* __restrict__ v2) {
    __shared__ float red[4];
    const int t = blockIdx.x, tid = threadIdx.x;
    float cv[4];
#pragma unroll
    for (int i = 0; i < 4; ++i) {
        const int c = tid + 256 * i;
        float a = conv_b[c];
        for (int j = 0; j < 31; ++j) {
            const int s = t - 30 + j;
            if (s >= 0) { const float ga = proj[(size_t)s * DIN + OFF_A + c], gb = proj[(size_t)s * DIN + OFF_B + c]; a += conv_w[j * 1024 + c] * (ga * sigmoidf_(gb)); }
        }
        cv[i] = a;
    }
    const float mean = block_sum_256(cv[0] + cv[1] + cv[2] + cv[3], red) * (1.f / 1024.f);
    float q = 0.f;
#pragma unroll
    for (int i = 0; i < 4; ++i) { cv[i] -= mean; q += cv[i] * cv[i]; }
    const float var = block_sum_256(q, red) * (1.f / 1024.f);
    const float rstd = rsqrtf(var + LN_EPS);
#pragma unroll
    for (int i = 0; i < 4; ++i) { const int c = tid + 256 * i; const float y = cv[i] * rstd * g[c] + b[c]; v2[(size_t)t * DC + c] = siluf_(y); }
}

__global__ void __launch_bounds__(256) k_ln(float* __restrict__ z, const float* __restrict__ g, const float* __restrict__ b) {
    __shared__ float red[4];
    const int t = blockIdx.x, tid = threadIdx.x;
    float v[8]; float s = 0.f;
#pragma unroll
    for (int i = 0; i < 8; ++i) { v[i] = z[(size_t)t * DM + tid + 256 * i]; s += v[i]; }
    const float mean = block_sum_256(s, red) * (1.f / 2048.f);
    float q = 0.f;
#pragma unroll
    for (int i = 0; i < 8; ++i) { v[i] -= mean; q += v[i] * v[i]; }
    const float rstd = rsqrtf(block_sum_256(q, red) * (1.f / 2048.f) + LN_EPS);
#pragma unroll
    for (int i = 0; i < 8; ++i) { const int c = tid + 256 * i; z[(size_t)t * DM + c] = v[i] * rstd * g[c] + b[c]; }
}

extern "C" void kernel_launch(void* const* d_in, const int* in_sizes, int n_in, void* d_out, int out_size, void* d_ws, size_t ws_size, hipStream_t stream) {
    const float* x = (const float*)d_in[0];      const float* c = (const float*)d_in[1];
    const float* w_ada = (const float*)d_in[2];  const float* b_ada = (const float*)d_in[3];
    const float* w_in = (const float*)d_in[4];   const float* rel_bias = (const float*)d_in[5];
    const float* sinks = (const float*)d_in[6];  const float* conv_w = (const float*)d_in[7];
    const float* conv_b = (const float*)d_in[8]; const float* cln_g = (const float*)d_in[9];
    const float* cln_b = (const float*)d_in[10]; const float* w_pw = (const float*)d_in[11];
    const float* b_pw = (const float*)d_in[12];  const float* w_out = (const float*)d_in[13];
    const float* ln_g = (const float*)d_in[14];  const float* ln_b = (const float*)d_in[15];
    float* out = (float*)d_out;
    char* ws = (char*)d_ws;
    float* mod = (float*)ws;
    float* proj = (float*)(ws + (1u << 20));
    float* ycat = (float*)(ws + (1u << 20) + (size_t)SEQ * DIN * 4);
    float* v2 = out;
    if (ws_size < (1u << 20) + (size_t)SEQ * DIN * 4 + (size_t)SEQ * DM * 4) { fprintf(stderr, "workspace too small\n"); return; }

    k_mod<<<6144 / 64, 512, 0, stream>>>(c, w_ada, b_ada, mod);
    k_sgemm<0><<<dim3(DIN / 64, SEQ / 64), 256, 0, stream>>>(x, DM, w_in, DIN, proj, DIN, DM, mod + 2048  , mod  );
    k_attn<<<SEQ * 16 / 4, 256, 0, stream>>>(proj, rel_bias, sinks, ycat);
    k_conv<<<SEQ, 256, 0, stream>>>(proj, conv_w, conv_b, cln_g, cln_b, v2);
    k_sgemm<1><<<dim3(DC / 64, SEQ / 64), 256, 0, stream>>>(v2, DC, w_pw, DC, ycat, DM, DC, b_pw, proj + OFF_GC);
    k_sgemm<2><<<dim3(DM / 64, SEQ / 64), 256, 0, stream>>>(ycat, DM, w_out, DM, out, DM, DM, x, mod + 4096  );
    k_ln<<<SEQ, 256, 0, stream>>>(out, ln_g, ln_b);
}
```
